# Optimizing an MI355X kernel written in HIP

```python
import jax, jax.numpy as jnp
from jax import lax
import numpy as np


D_MODEL = 1024
BATCH = 8
SEQ = 2048
DEPTH = 4

HEAD_DIM = 64
ROPE_DIM = HEAD_DIM // 4
ROPE_THETA = 500000.0
NORM_EPS = 1e-6
NEG = -1e30
BAND_BLOCK = 128
MAX_POS_OFFSET = 4096

NSA_HEADS = D_MODEL // HEAD_DIM
NSA_KV_HEADS = 4
NSA_GROUP = NSA_HEADS // NSA_KV_HEADS
CMP_BLOCK = 32
CMP_STRIDE = 16
CMP_HIDDEN = 4 * HEAD_DIM
SEL_BLOCK = 64
SEL_TOPN = 8
FORCE_SCORE = 1e4
WIN = 512
NSA_Q_CHUNK = 64
NSA_IN = NSA_HEADS * HEAD_DIM + 6 * NSA_KV_HEADS * HEAD_DIM + 3 * NSA_HEADS

DIL_PATTERNS = ((128, 1), (512, 4), (2048, 16))
N_DIL = len(DIL_PATTERNS)
DIL_HEADS = D_MODEL // HEAD_DIM
DIL_IN = N_DIL * 3 * DIL_HEADS * HEAD_DIM

D_FF = ((8 * D_MODEL + 3 * 256 - 1) // (3 * 256)) * 256

N_NSA_LAYERS = (DEPTH + 1) // 2
N_DIL_LAYERS = DEPTH // 2

kernel_name = 'hybrid_nsa_dilated_swiglu_trunk'


def rmsnorm(x, g):
    xf = x.astype(jnp.float32)
    y = xf * lax.rsqrt(jnp.mean(xf * xf, axis=-1, keepdims=True) + NORM_EPS)
    return (y * g.astype(jnp.float32)).astype(x.dtype)


def rope_tables(positions):
    inv = ROPE_THETA ** (-jnp.arange(0, ROPE_DIM, 2, dtype=jnp.float32) / ROPE_DIM)
    ang = positions.astype(jnp.float32)[..., None] * inv
    return jnp.cos(ang)[:, :, None, :], jnp.sin(ang)[:, :, None, :]


def partial_rope(x, cos, sin):
    half = ROPE_DIM // 2
    x1 = x[..., :half].astype(jnp.float32)
    x2 = x[..., half:ROPE_DIM].astype(jnp.float32)
    rot = jnp.concatenate([x1 * cos - x2 * sin, x2 * cos + x1 * sin], axis=-1).astype(x.dtype)
    return jnp.concatenate([rot, x[..., ROPE_DIM:]], axis=-1)


def banded_attention(q, k, v, max_dist):
    n, L, hkv, g, dh = q.shape
    nb = -(-L // BAND_BLOCK)
    Lp = nb * BAND_BLOCK
    kw = BAND_BLOCK + max_dist
    qp = jnp.pad(q, ((0, 0), (0, Lp - L), (0, 0), (0, 0), (0, 0)))
    kp = jnp.pad(k, ((0, 0), (max_dist, Lp - L), (0, 0), (0, 0)))
    vp = jnp.pad(v, ((0, 0), (max_dist, Lp - L), (0, 0), (0, 0)))
    qb = qp.reshape(n, nb, BAND_BLOCK, hkv, g, dh).swapaxes(0, 1)
    rel = jnp.arange(BAND_BLOCK)[:, None] + max_dist - jnp.arange(kw)[None, :]
    band = (rel >= 0) & (rel <= max_dist)
    scale = dh ** -0.5

    def block(args):
        c, qc = args
        start = c * BAND_BLOCK
        kc = lax.dynamic_slice_in_dim(kp, start, kw, axis=1)
        vc = lax.dynamic_slice_in_dim(vp, start, kw, axis=1)
        kpos = start - max_dist + jnp.arange(kw)
        mask = band & (kpos >= 0)[None, :]
        s = jnp.einsum('nqhgd,nkhd->nhgqk', qc, kc).astype(jnp.float32) * scale
        s = jnp.where(mask, s, NEG)
        m = jnp.max(s, axis=-1, keepdims=True)
        p = jnp.exp(s - m)
        l = jnp.sum(p, axis=-1, keepdims=True)
        o = jnp.einsum('nhgqk,nkhd->nqhgd', (p / l).astype(vc.dtype), vc)
        lse = (m + jnp.log(l))[..., 0].transpose(0, 3, 1, 2)
        return o, lse

    o, lse = lax.map(block, (jnp.arange(nb), qb))
    o = o.swapaxes(0, 1).reshape(n, Lp, hkv, g, dh)[:, :L]
    lse = lse.swapaxes(0, 1).reshape(n, Lp, hkv, g)[:, :L]
    return o, lse


def nsa_mixer(a, cos, sin, w_in, cmp_pos, cmp_wk1, cmp_wk2, cmp_wv1, cmp_wv2, w_o):
    B, S, _ = a.shape
    H, HK, G, DH = NSA_HEADS, NSA_KV_HEADS, NSA_GROUP, HEAD_DIM
    dq, dkv = H * DH, HK * DH
    scale = DH ** -0.5
    proj = a @ w_in
    q = proj[..., :dq].reshape(B, S, H, DH)
    kv = proj[..., dq:dq + 6 * dkv].reshape(B, S, 6, HK, DH)
    k_cmp, v_cmp, k_sel, v_sel, k_win, v_win = [kv[:, :, i] for i in range(6)]
    gates = jax.nn.sigmoid(proj[..., dq + 6 * dkv:].astype(jnp.float32)).reshape(B, S, 3, HK, G)
    q_grp = q.reshape(B, S, HK, G, DH)
    q_rot = partial_rope(q, cos, sin).reshape(B, S, HK, G, DH)
    k_sel = partial_rope(k_sel, cos, sin)
    k_win = partial_rope(k_win, cos, sin)
    pos = jnp.arange(S)

    n_cmp = (S - CMP_BLOCK) // CMP_STRIDE + 1
    blk = jnp.arange(n_cmp)[:, None] * CMP_STRIDE + jnp.arange(CMP_BLOCK)[None, :]

    def compress(t, w1, w2):
        tb = t[:, blk] + cmp_pos[None, None, :, None, :]
        tb = tb.transpose(0, 1, 3, 2, 4).reshape(B, n_cmp, HK, CMP_BLOCK * DH)
        return jax.nn.silu(tb @ w1) @ w2

    kc = compress(k_cmp, cmp_wk1, cmp_wk2)
    vc = compress(v_cmp, cmp_wv1, cmp_wv2)
    c_start = jnp.arange(n_cmp) * CMP_STRIDE
    c_valid = (c_start + CMP_BLOCK - 1)[None, :] <= pos[:, None]
    s_cmp = jnp.einsum('bthgd,bchd->bhgtc', q_grp, kc).astype(jnp.float32) * scale
    p_cmp = jax.nn.softmax(jnp.where(c_valid, s_cmp, NEG), axis=-1) * c_valid
    o_cmp = jnp.einsum('bhgtc,bchd->bthgd', p_cmp.astype(vc.dtype), vc)

    n_sel = S // SEL_BLOCK
    top_n = min(SEL_TOPN, n_sel)
    j_start = jnp.arange(n_sel) * SEL_BLOCK
    overlap = ((c_start[:, None] < j_start[None, :] + SEL_BLOCK)
               & (c_start[:, None] + CMP_BLOCK > j_start[None, :])).astype(jnp.float32)
    imp = jnp.einsum('bhgtc,cj->bhtj', p_cmp, overlap)
    jb = jnp.arange(n_sel)[None, :]
    tb = (pos // SEL_BLOCK)[:, None]
    forced = (jb == 0) | (jb == tb) | (jb == tb - 1)
    score = jnp.where(forced, FORCE_SCORE, jnp.where(jb <= tb, imp, -1.0))
    _, sel_idx = lax.top_k(score, top_n)

    n_ch = S // NSA_Q_CHUNK
    n_key = top_n * SEL_BLOCK
    kb = k_sel.reshape(B, n_sel, SEL_BLOCK, HK, DH).transpose(0, 3, 1, 2, 4)
    vb = v_sel.reshape(B, n_sel, SEL_BLOCK, HK, DH).transpose(0, 3, 1, 2, 4)
    q_ch = q_rot.reshape(B, n_ch, NSA_Q_CHUNK, HK, G, DH).swapaxes(0, 1)
    i_ch = sel_idx.reshape(B, HK, n_ch, NSA_Q_CHUNK, top_n).transpose(2, 0, 1, 3, 4)
    gather = jax.vmap(jax.vmap(lambda blocks, ids: blocks[ids]))

    def sel_chunk(args):
        c, qc, ic = args
        kg = gather(kb, ic).reshape(B, HK, NSA_Q_CHUNK, n_key, DH)
        vg = gather(vb, ic).reshape(B, HK, NSA_Q_CHUNK, n_key, DH)
        kpos = (ic[..., None] * SEL_BLOCK + jnp.arange(SEL_BLOCK)).reshape(B, HK, NSA_Q_CHUNK, n_key)
        qpos = c * NSA_Q_CHUNK + jnp.arange(NSA_Q_CHUNK)
        mask = (kpos <= qpos[:, None])[:, :, None]
        s = jnp.einsum('bqhgd,bhqkd->bhgqk', qc, kg).astype(jnp.float32) * scale
        p = jax.nn.softmax(jnp.where(mask, s, NEG), axis=-1)
        return jnp.einsum('bhgqk,bhqkd->bqhgd', p.astype(vg.dtype), vg)

    o_sel = lax.map(sel_chunk, (jnp.arange(n_ch), q_ch, i_ch))
    o_sel = o_sel.swapaxes(0, 1).reshape(B, S, HK, G, DH)

    o_win, _ = banded_attention(q_rot, k_win, v_win, WIN - 1)

    branches = jnp.stack([o_cmp, o_sel, o_win], axis=2)
    o = jnp.sum(gates[..., None].astype(branches.dtype) * branches, axis=2)
    return o.reshape(B, S, H * DH) @ w_o


def to_residue(t, dil):
    B, S, H, DH = t.shape
    return t.reshape(B, S // dil, dil, H, DH).swapaxes(1, 2).reshape(B * dil, S // dil, H, DH)


def from_residue(t, B, dil):
    rest = t.shape[2:]
    L = t.shape[1]
    return t.reshape((B, dil, L) + rest).swapaxes(1, 2).reshape((B, L * dil) + rest)


def dilated_mixer(a, cos, sin, w_in, w_o):
    B, S, _ = a.shape
    H, DH = DIL_HEADS, HEAD_DIM
    proj = (a @ w_in).reshape(B, S, N_DIL, 3, H, DH)
    outs, lses = [], []
    for gi, (window, dil) in enumerate(DIL_PATTERNS):
        q = partial_rope(proj[:, :, gi, 0], cos, sin)
        k = partial_rope(proj[:, :, gi, 1], cos, sin)
        v = proj[:, :, gi, 2]
        o, lse = banded_attention(to_residue(q, dil)[:, :, :, None], to_residue(k, dil),
                                  to_residue(v, dil), window // dil)
        outs.append(from_residue(o[:, :, :, 0], B, dil))
        lses.append(from_residue(lse[:, :, :, 0], B, dil))
    alpha = jax.nn.softmax(jnp.stack(lses, axis=-1), axis=-1)
    o = jnp.einsum('bshn,bshnd->bshd', alpha.astype(a.dtype), jnp.stack(outs, axis=3))
    return o.reshape(B, S, H * DH) @ w_o


def swiglu(h, w_gu, w_down):
    gu = h @ w_gu
    g, u = gu[..., :D_FF], gu[..., D_FF:]
    return (jax.nn.silu(g) * u) @ w_down


def setup_inputs(seed: int = 0) -> dict:
    key = jax.random.key(seed)
    ks = jax.random.split(key, 20)
    f32 = jnp.float32

    def nrm(k, shape, fan_in):
        return jax.random.normal(k, shape, f32) * (fan_in ** -0.5)

    def gain(k, shape):
        return 1.0 + 0.02 * jax.random.normal(k, shape, f32)

    nA, nB = N_NSA_LAYERS, N_DIL_LAYERS
    x = jax.random.normal(ks[0], (BATCH, SEQ, D_MODEL), f32)
    positions = (jax.random.randint(ks[1], (BATCH, 1), 0, MAX_POS_OFFSET, jnp.int32)
                 + jnp.arange(SEQ, dtype=jnp.int32)[None, :])
    return {
        'x': x,
        'positions': positions,
        'norm_mix_pre': gain(ks[2], (DEPTH, D_MODEL)),
        'norm_mix_post': gain(ks[3], (DEPTH, D_MODEL)),
        'norm_ffn_pre': gain(ks[4], (DEPTH, D_MODEL)),
        'norm_ffn_post': gain(ks[5], (DEPTH, D_MODEL)),
        'ffn_w_gu': nrm(ks[6], (DEPTH, D_MODEL, 2 * D_FF), D_MODEL),
        'ffn_w_down': nrm(ks[7], (DEPTH, D_FF, D_MODEL), D_FF),
        'nsa_w_in': nrm(ks[8], (nA, D_MODEL, NSA_IN), D_MODEL),
        'nsa_cmp_pos': 0.1 * jax.random.normal(ks[9], (nA, CMP_BLOCK, HEAD_DIM), f32),
        'nsa_cmp_wk1': nrm(ks[10], (nA, CMP_BLOCK * HEAD_DIM, CMP_HIDDEN), CMP_BLOCK * HEAD_DIM),
        'nsa_cmp_wk2': nrm(ks[11], (nA, CMP_HIDDEN, HEAD_DIM), CMP_HIDDEN),
        'nsa_cmp_wv1': nrm(ks[12], (nA, CMP_BLOCK * HEAD_DIM, CMP_HIDDEN), CMP_BLOCK * HEAD_DIM),
        'nsa_cmp_wv2': nrm(ks[13], (nA, CMP_HIDDEN, HEAD_DIM), CMP_HIDDEN),
        'nsa_w_o': nrm(ks[14], (nA, NSA_HEADS * HEAD_DIM, D_MODEL), NSA_HEADS * HEAD_DIM),
        'dil_w_in': nrm(ks[15], (nB, D_MODEL, DIL_IN), D_MODEL),
        'dil_w_o': nrm(ks[16], (nB, DIL_HEADS * HEAD_DIM, D_MODEL), DIL_HEADS * HEAD_DIM),
    }


def reference(x, positions, norm_mix_pre, norm_mix_post, norm_ffn_pre, norm_ffn_post,
              ffn_w_gu, ffn_w_down, nsa_w_in, nsa_cmp_pos, nsa_cmp_wk1, nsa_cmp_wk2,
              nsa_cmp_wv1, nsa_cmp_wv2, nsa_w_o, dil_w_in, dil_w_o):
    cos, sin = rope_tables(positions)
    h = x
    for i in range(DEPTH):
        j = i // 2
        a = rmsnorm(h, norm_mix_pre[i])
        if i % 2 == 0:
            m = nsa_mixer(a, cos, sin, nsa_w_in[j], nsa_cmp_pos[j], nsa_cmp_wk1[j], nsa_cmp_wk2[j],
                          nsa_cmp_wv1[j], nsa_cmp_wv2[j], nsa_w_o[j])
        else:
            m = dilated_mixer(a, cos, sin, dil_w_in[j], dil_w_o[j])
        h = h + rmsnorm(m, norm_mix_post[i])
        f = swiglu(rmsnorm(h, norm_ffn_pre[i]), ffn_w_gu[i], ffn_w_down[i])
        h = h + rmsnorm(f, norm_ffn_post[i])
    return h
```

```cpp
#include <hip/hip_runtime.h>
#include <hip/hip_cooperative_groups.h>
#include <cstdio>
#include <cstdint>

#ifndef MK_ONE_LAUNCH
#define MK_ONE_LAUNCH 0
#endif

#define LAS __attribute__((address_space(3)))
#define GAS __attribute__((address_space(1)))
typedef unsigned short bf16_t;
typedef short bf16x8 __attribute__((ext_vector_type(8)));
typedef float f32x4 __attribute__((ext_vector_type(4)));
typedef float f32x16 __attribute__((ext_vector_type(16)));
typedef unsigned u32x4 __attribute__((ext_vector_type(4)));
typedef unsigned u32x2 __attribute__((ext_vector_type(2)));
typedef float f32x2_t __attribute__((ext_vector_type(2)));
typedef __bf16 bf16x2_t __attribute__((ext_vector_type(2)));

constexpr int BATCH = 8, SEQ = 2048, DM = 1024, MTOK = BATCH * SEQ, DEPTH = 4;
constexpr int DFF = 2816, NSA_IN = 2608, NSA_INP = 2816, DIL_IN = 9216;
constexpr float NORM_EPS = 1e-6f;
constexpr float SC_LOG2 = 0.125f * 1.4426950408889634f;

constexpr size_t MiB = 1u << 20;
constexpr size_t WS_CTL = 0, CTL_ZERO_BYTES = 1 * MiB;
constexpr size_t WS_ROPE = 1 * MiB;
constexpr size_t WS_RSTD = 2 * MiB;
constexpr size_t WS_BIAS1 = 2 * MiB + 128 * 1024;
constexpr size_t WS_PART = 3 * MiB;
constexpr size_t WS_LSE = 4 * MiB;
constexpr size_t WS_WGU = 8 * MiB;
constexpr size_t WS_WDN = 52 * MiB;
constexpr size_t WS_WNI = 74 * MiB;
constexpr size_t WS_WNO = 85 * MiB;
constexpr size_t WS_WDI = 89 * MiB;
constexpr size_t WS_WDO = 125 * MiB;
constexpr size_t WS_WC1 = 129 * MiB;
constexpr size_t WS_WC2 = 133 * MiB;
constexpr size_t WS_HB = 134 * MiB;
constexpr size_t WS_S = 166 * MiB;
constexpr size_t S_ACT = WS_S + 0;
constexpr size_t S_O = WS_S + 96 * MiB;
constexpr size_t S_M = WS_S + 128 * MiB;
constexpr size_t S_QP = WS_S + 0, S_QR = WS_S + 32 * MiB, S_KCMP = WS_S + 64 * MiB, S_VCMP = WS_S + 73 * MiB, S_KSEL = WS_S + 82 * MiB;
constexpr size_t S_VT = WS_S + 128 * MiB, S_GATES = WS_S + 144 * MiB, S_KC = WS_S + 147 * MiB, S_VCT = WS_S + 148 * MiB, S_KWIN = WS_S + 150 * MiB;
constexpr size_t S_DQ = WS_S + 0;
constexpr size_t S_DK = WS_S + 96 * MiB, S_DV = WS_S + 128 * MiB;
constexpr size_t WS_END = WS_S + 160 * MiB;

__device__ __forceinline__ unsigned cvtpk(float lo, float hi) { f32x2_t v = {lo, hi}; bf16x2_t b = __builtin_convertvector(v, bf16x2_t); return __builtin_bit_cast(unsigned, b); }
__device__ __forceinline__ float bf2f(bf16_t x) { return __uint_as_float(((unsigned)x) << 16); }
__device__ __forceinline__ float bflo(unsigned w) { return __uint_as_float(w << 16); }
__device__ __forceinline__ float bfhi(unsigned w) { return __uint_as_float(w & 0xffff0000u); }
__device__ __forceinline__ float wave_sum(float v) {
#pragma unroll
    for (int o = 1; o < 64; o <<= 1) v += __shfl_xor(v, o);
    return v;
}
__device__ __forceinline__ int swap12(int q) { return ((q & 1) << 1) | (q >> 1); }

__device__ __forceinline__ int tile_base_row(int dil, int t) {
    if (dil == 1) return t * 256;
    const int b = t >> 3, ti = t & 7;
    if (dil == 4) return b * 2048 + 4 * ((ti & 1) * 256) + (ti >> 1);
    return b * 2048 + 2 * ti;
}
__device__ __forceinline__ int half_rows(int dil) { return dil == 16 ? 1 : 128 * dil; }
__device__ __forceinline__ int row_token(int dil, int c) {
    if (dil == 1) return c;
    const int b = c >> 11, rl = c & 2047;
    const int sh = (dil == 4) ? 9 : 7;
    const int r = rl >> sh, l = rl & ((1 << sh) - 1);
    return b * 2048 + l * dil + r;
}

namespace pg8 {
constexpr int BM = 256, BK = 64, HALF = 128, HTB = HALF * BK * 2, STAGE_BYTES = 8 * HTB, NXCD = 8, WGM = 8;
__host__ __device__ __forceinline__ int lds_byte(int r, int c) { const int st = (r >> 4) * 2 + (c >> 5), rr = r & 15, cc = c & 31, ob = rr * 64 + cc * 2; return st * 1024 + (ob ^ (((ob >> 9) & 1) << 5)); }
__host__ __device__ __forceinline__ void stage_rc(int b, int& R, int& C) { const int st = b / 1024, sb = b % 1024, swz = sb ^ (((sb >> 9) & 1) << 5); R = (st >> 1) * 16 + swz / 64; C = (st & 1) * 32 + (swz % 64) / 2; }
__host__ __device__ __forceinline__ int perm32(int rho) { const int n = rho >> 4, i = rho & 15; return 8 * (i >> 2) + 4 * n + (i & 3); }

struct Unit { int pm, pn; };
struct Opnd { const bf16_t* p; int ld; int dil; };
struct Gemm { Opnd A, B; int M, N, K; };

struct StaticOrder {
    int nM, nN, nwg, G, c;
    __host__ __device__ void init(int M, int N, int G_, int c_) { nM = M / BM; nN = N / BM; nwg = nM * nN; G = G_; c = c_; }
    __host__ __device__ bool next(int i, Unit& u) const {
        const long L = (long)i * G + c; if (L >= nwg) return false;
        int wgid = (int)L; { const int q = nwg / NXCD, r = nwg % NXCD, xcd = wgid % NXCD, off = wgid / NXCD; wgid = (xcd < r ? xcd * (q + 1) : r * (q + 1) + (xcd - r) * q) + off; }
        const int nig = WGM * nN, gid = wgid / nig, fm = gid * WGM, gsz = (nM - fm) < WGM ? (nM - fm) : WGM;
        u.pm = fm + ((wgid % nig) % gsz); u.pn = (wgid % nig) / gsz; return true;
    }
};

template <class Epi, class Sched, bool ALIGN_EPI = true, bool SP2 = true>
__device__ __forceinline__ void gemm_phase(LAS unsigned char* lds, const Gemm g, const Sched& S, const Epi& E) {
    int tid = threadIdx.x; asm volatile("" : "+v"(tid));
    const int wid = __builtin_amdgcn_readfirstlane(tid >> 6), lane = tid & 63, wr = wid >> 2, wc = wid & 3, fr = lane & 15, fq = lane >> 4;
    const int K = g.K, nt = K / BK;
    unsigned voffA[2], voffB[2];
#pragma unroll
    for (int i = 0; i < 2; ++i) { int R, C; stage_rc(tid * 16 + i * 8192, R, C); const int Rb = Epi::PERM ? ((R & ~31) + perm32(R & 31)) : R;
        voffA[i] = (unsigned)(R * g.A.dil * g.A.ld + C) * 2u; voffB[i] = (unsigned)(Rb * g.B.dil * g.B.ld + C) * 2u; }
    const size_t kstep = (size_t)(BK * 2);
    const size_t hstepA = (size_t)half_rows(g.A.dil) * g.A.ld * 2, hstepB = (size_t)half_rows(g.B.dil) * g.B.ld * 2;
    const unsigned ldsw = (unsigned)wid * 1024u;
    const int aoff = lds_byte(wr * 64 + fr, fq * 8), boff = lds_byte(wc * 32 + fr, fq * 8);
#define PG8_SA(b, h) (((b) * 2 + (h)) * HTB)
#define PG8_SB(b, h) ((4 + (b) * 2 + (h)) * HTB)
#define PG8_STAGE(bufoff, gbase, voff) do { _Pragma("unroll") for (int _i = 0; _i < 2; ++_i) \
        __builtin_amdgcn_global_load_lds((const unsigned*)((const char*)(gbase) + (voff)[_i]), (LAS unsigned*)(lds + (bufoff) + ldsw + _i * 8192), 16, 0, 0); } while (0)
#define PG8_LDA(dst, b, h) do { _Pragma("unroll") for (int m = 0; m < 4; ++m) _Pragma("unroll") for (int k = 0; k < 2; ++k) dst[m][k] = *(const LAS bf16x8*)(lds + PG8_SA(b, h) + aoff + m * 2048 + k * 1024); } while (0)
#define PG8_LDB(dst, b, h) do { _Pragma("unroll") for (int n = 0; n < 2; ++n) _Pragma("unroll") for (int k = 0; k < 2; ++k) dst[n][k] = *(const LAS bf16x8*)(lds + PG8_SB(b, h) + boff + n * 2048 + k * 1024); } while (0)
#define PG8_MMA(ai, bj, At, Bt) do { __builtin_amdgcn_s_setprio(1); _Pragma("unroll") for (int m = 0; m < 4; ++m) _Pragma("unroll") for (int n = 0; n < 2; ++n) _Pragma("unroll") for (int k = 0; k < 2; ++k) \
        acc[ai][bj][m][n] = __builtin_amdgcn_mfma_f32_16x16x32_bf16(Bt[n][k], At[m][k], acc[ai][bj][m][n], 0, 0, 0); __builtin_amdgcn_s_setprio(0); } while (0)
#define PG8_WAIT_V(n) asm volatile("s_waitcnt vmcnt(" #n ")" ::: "memory")
#define PG8_WAIT_L(n) asm volatile("s_waitcnt lgkmcnt(" #n ")" ::: "memory")
#define PG8_BAR __builtin_amdgcn_s_barrier()
#define PG8_SCHED __builtin_amdgcn_sched_barrier(0)
#define PG8_ABASE(u) ((const char*)g.A.p + (size_t)tile_base_row(g.A.dil, (u).pm) * g.A.ld * 2)
#define PG8_BBASE(u) ((const char*)g.B.p + (size_t)tile_base_row(g.B.dil, (u).pn) * g.B.ld * 2)
    Unit cur, nxt; int ui = 0;
    if (!S.next(0, cur)) return;
    f32x4 acc[2][2][4][2];
#pragma unroll
    for (int a = 0; a < 2; ++a)
#pragma unroll
        for (int b = 0; b < 2; ++b)
#pragma unroll
            for (int m = 0; m < 4; ++m)
#pragma unroll
                for (int n = 0; n < 2; ++n) acc[a][b][m][n] = (f32x4){0.f, 0.f, 0.f, 0.f};
    bf16x8 At[4][2], B0[2][2], B1[2][2];
    const char* cA = PG8_ABASE(cur); const char* cB = PG8_BBASE(cur);
    if constexpr (SP2) {
        PG8_STAGE(PG8_SB(0, 0), cB, voffB); PG8_STAGE(PG8_SB(0, 1), cB + hstepB, voffB); PG8_STAGE(PG8_SA(0, 0), cA, voffA); PG8_STAGE(PG8_SA(0, 1), cA + hstepA, voffA);
        if (wr == 1) PG8_BAR;
        PG8_WAIT_V(2); PG8_BAR;
        PG8_STAGE(PG8_SB(1, 0), cB + kstep, voffB); PG8_STAGE(PG8_SA(1, 0), cA + kstep, voffA); PG8_STAGE(PG8_SB(1, 1), cB + hstepB + kstep, voffB);
        PG8_WAIT_V(6); PG8_BAR;
    } else {
        PG8_STAGE(PG8_SB(0, 0), cB, voffB); PG8_STAGE(PG8_SA(0, 0), cA, voffA); PG8_STAGE(PG8_SB(0, 1), cB + hstepB, voffB); PG8_STAGE(PG8_SA(0, 1), cA + hstepA, voffA);
        if (wr == 1) PG8_BAR;
        PG8_WAIT_V(4); PG8_BAR;
        PG8_STAGE(PG8_SB(1, 0), cB + kstep, voffB); PG8_STAGE(PG8_SA(1, 0), cA + kstep, voffA); PG8_STAGE(PG8_SB(1, 1), cB + hstepB + kstep, voffB);
        PG8_WAIT_V(6); PG8_BAR;
    }
    for (;;) {
        const bool has_next = S.next(ui + 1, nxt);
        const char* nA = has_next ? PG8_ABASE(nxt) : cA; const char* nB = has_next ? PG8_BBASE(nxt) : cB;
        for (int t = 0; t < nt; t += 2) {
            const bool last = (t == nt - 2);
            const char* a1 = cA + (size_t)(t + 1) * kstep;
            const char* a2 = last ? nA : cA + (size_t)(t + 2) * kstep; const char* b2 = last ? nB : cB + (size_t)(t + 2) * kstep;
            const char* a3 = a2 + kstep; const char* b3 = b2 + kstep;
            if constexpr (SP2) {
            PG8_LDB(B0, 0, 0); PG8_LDB(B1, 0, 1); PG8_SCHED; PG8_LDA(At, 0, 0); PG8_STAGE(PG8_SA(1, 1), a1 + hstepA, voffA);
            PG8_WAIT_V(8); PG8_WAIT_L(0); PG8_BAR; PG8_MMA(0, 0, At, B0); PG8_MMA(0, 1, At, B1); PG8_BAR; PG8_SCHED;
            PG8_LDA(At, 0, 1); PG8_STAGE(PG8_SB(0, 0), b2, voffB); PG8_STAGE(PG8_SB(0, 1), b2 + hstepB, voffB); PG8_STAGE(PG8_SA(0, 0), a2, voffA);
            PG8_WAIT_V(8); PG8_WAIT_L(0); PG8_BAR; PG8_MMA(1, 0, At, B0); PG8_MMA(1, 1, At, B1); PG8_BAR; PG8_SCHED;
            PG8_LDB(B0, 1, 0); PG8_LDB(B1, 1, 1); PG8_SCHED; PG8_LDA(At, 1, 0); PG8_STAGE(PG8_SA(0, 1), a2 + hstepA, voffA);
            PG8_WAIT_V(8); PG8_WAIT_L(0); PG8_BAR; PG8_MMA(0, 0, At, B0); PG8_MMA(0, 1, At, B1); PG8_BAR; PG8_SCHED;
            PG8_LDA(At, 1, 1); PG8_STAGE(PG8_SB(1, 0), b3, voffB); PG8_STAGE(PG8_SB(1, 1), b3 + hstepB, voffB); PG8_STAGE(PG8_SA(1, 0), a3, voffA);
            PG8_WAIT_V(8); PG8_WAIT_L(0); PG8_BAR; PG8_MMA(1, 0, At, B0); PG8_MMA(1, 1, At, B1); PG8_BAR; PG8_SCHED;
            } else {
            PG8_LDB(B0, 0, 0); PG8_SCHED; PG8_LDA(At, 0, 0); PG8_STAGE(PG8_SA(1, 1), a1 + hstepA, voffA);
            PG8_WAIT_L(8); PG8_BAR; PG8_WAIT_L(0); PG8_MMA(0, 0, At, B0); PG8_BAR; PG8_SCHED;
            PG8_LDB(B1, 0, 1); PG8_STAGE(PG8_SB(0, 0), b2, voffB);
            PG8_BAR; PG8_WAIT_L(0); PG8_MMA(0, 1, At, B1); PG8_BAR;
            PG8_LDA(At, 0, 1); PG8_STAGE(PG8_SA(0, 0), a2, voffA);
            PG8_BAR; PG8_WAIT_L(0); PG8_MMA(1, 0, At, B0); PG8_BAR; PG8_SCHED;
            PG8_STAGE(PG8_SB(0, 1), b2 + hstepB, voffB);
            PG8_WAIT_V(6); PG8_BAR; PG8_MMA(1, 1, At, B1); PG8_BAR;
            PG8_LDB(B0, 1, 0); PG8_SCHED; PG8_LDA(At, 1, 0); PG8_STAGE(PG8_SA(0, 1), a2 + hstepA, voffA);
            PG8_WAIT_L(8); PG8_BAR; PG8_WAIT_L(0); PG8_MMA(0, 0, At, B0); PG8_BAR; PG8_SCHED;
            PG8_LDB(B1, 1, 1); PG8_STAGE(PG8_SB(1, 0), b3, voffB);
            PG8_BAR; PG8_WAIT_L(0); PG8_MMA(0, 1, At, B1); PG8_BAR;
            PG8_LDA(At, 1, 1); PG8_STAGE(PG8_SA(1, 0), a3, voffA);
            PG8_BAR; PG8_WAIT_L(0); PG8_MMA(1, 0, At, B0); PG8_BAR; PG8_SCHED;
            PG8_STAGE(PG8_SB(1, 1), b3 + hstepB, voffB);
            PG8_WAIT_V(6); PG8_BAR; PG8_MMA(1, 1, At, B1); PG8_BAR;
            }
        }
        if constexpr (ALIGN_EPI) { if (wr == 0) PG8_BAR; }
        E(acc, cur, wr, wc, fr, fq);
        if (!has_next) break;
#pragma unroll
        for (int a = 0; a < 2; ++a)
#pragma unroll
            for (int b = 0; b < 2; ++b)
#pragma unroll
                for (int m = 0; m < 4; ++m)
#pragma unroll
                    for (int n = 0; n < 2; ++n) acc[a][b][m][n] = (f32x4){0.f, 0.f, 0.f, 0.f};
        cur = nxt; cA = nA; cB = nB; ++ui;
        if constexpr (ALIGN_EPI) { if (wr == 1) PG8_BAR; }
    }
    PG8_WAIT_V(0);
    if constexpr (!ALIGN_EPI) { if (wr == 0) PG8_BAR; }
    PG8_BAR;
#undef PG8_SA
#undef PG8_SB
#undef PG8_STAGE
#undef PG8_LDA
#undef PG8_LDB
#undef PG8_MMA
#undef PG8_WAIT_V
#undef PG8_WAIT_L
#undef PG8_BAR
#undef PG8_SCHED
#undef PG8_ABASE
#undef PG8_BBASE
}

__device__ __forceinline__ u32x4 pack8(const f32x4& a, const f32x4& b) { u32x4 w; w.x = cvtpk(a[0], a[1]); w.y = cvtpk(a[2], a[3]); w.z = cvtpk(b[0], b[1]); w.w = cvtpk(b[2], b[3]); return w; }

struct EpiProj {
    static constexpr bool PERM = true;
    int mode, dil;
    const float* rstd; const float* rcos; const float* rsin;
    bf16_t *t0, *t1, *t2, *t3, *t4, *t5; float* gates;
    __device__ __forceinline__ void operator()(const f32x4 (&acc)[2][2][4][2], const Unit& u, int wr, int wc, int fr, int fq) const {
        bf16_t* plain = nullptr; bf16_t* roped = nullptr; int nh = 16, head0 = 0; bool isg = false;
        if (mode == 0) {
            if (u.pn < 4) { plain = t0; roped = t1; head0 = 4 * u.pn; }
            else { nh = 4; if (u.pn == 4) plain = t2; else if (u.pn == 5) plain = t3; else if (u.pn == 6) roped = t4; else if (u.pn == 7) roped = t5; else isg = true; }
        } else { if (u.pn < 4) { roped = t0; head0 = 4 * u.pn; } else { roped = t1; head0 = 4 * (u.pn - 4); } }
        const int hl = wc >> 1, d0 = (wc & 1) * 32 + fq * 8;
        const bool ropew = (roped != nullptr) && ((wc & 1) == 0);
#pragma unroll
        for (int ai = 0; ai < 2; ++ai)
#pragma unroll
            for (int m = 0; m < 4; ++m) {
                const int c = u.pm * 256 + ai * 128 + wr * 64 + m * 16 + fr;
                const int tok = row_token(dil, c);
                const float rs = rstd[tok];
                const int b = c >> 11, rl = c & 2047;
                f32x4 cs0 = {1.f, 1.f, 1.f, 1.f}, cs1 = cs0, sn0 = {0.f, 0.f, 0.f, 0.f}, sn1 = sn0;
                if (ropew && fq < 2) {
                    cs0 = *(const f32x4*)(rcos + (size_t)tok * 8); cs1 = *(const f32x4*)(rcos + (size_t)tok * 8 + 4);
                    sn0 = *(const f32x4*)(rsin + (size_t)tok * 8); sn1 = *(const f32x4*)(rsin + (size_t)tok * 8 + 4);
                    if (fq == 0) { sn0 = -sn0; sn1 = -sn1; }
                }
#pragma unroll
                for (int bj = 0; bj < 2; ++bj) {
                    f32x4 v0 = acc[ai][bj][m][0] * rs, v1 = acc[ai][bj][m][1] * rs;
                    if (isg) {
                        if (bj == 0 && (wc == 0 || (wc == 1 && fq < 2))) {
#pragma unroll
                            for (int j = 0; j < 4; ++j) { v0[j] = 1.f / (1.f + __expf(-v0[j])); v1[j] = 1.f / (1.f + __expf(-v1[j])); }
                            float* gp = gates + (size_t)tok * 48 + wc * 32 + fq * 8;
                            *(f32x4*)gp = v0; *(f32x4*)(gp + 4) = v1;
                        }
                        continue;
                    }
                    const int head = head0 + 2 * bj + hl;
                    const size_t off = ((size_t)(b * nh + head) * 2048 + rl) * 64 + d0;
                    if (plain) *(u32x4*)(plain + off) = pack8(v0, v1);
                    if (roped) {
                        if (ropew) {
                            f32x4 p0, p1;
#pragma unroll
                            for (int j = 0; j < 4; ++j) { p0[j] = __shfl_xor(v0[j], 16); p1[j] = __shfl_xor(v1[j], 16); }
                            v0 = v0 * cs0 + p0 * sn0; v1 = v1 * cs1 + p1 * sn1;
                        }
                        *(u32x4*)(roped + off) = pack8(v0, v1);
                    }
                }
            }
    }
};

struct EpiVT {
    static constexpr bool PERM = false;
    bf16_t* vt; int nh, dil; const float* rstd;
    __device__ __forceinline__ void operator()(const f32x4 (&acc)[2][2][4][2], const Unit& u, int wr, int wc, int fr, int fq) const {
        f32x4 rs[2][2];
#pragma unroll
        for (int bj = 0; bj < 2; ++bj)
#pragma unroll
            for (int n = 0; n < 2; ++n) { const int c0 = u.pn * 256 + bj * 128 + wc * 32 + 16 * n + 4 * fq;
#pragma unroll
                for (int j = 0; j < 4; ++j) rs[bj][n][j] = rstd[row_token(dil, c0 + j)]; }
        const int b = (u.pn * 256) >> 11;
#pragma unroll
        for (int ai = 0; ai < 2; ++ai)
#pragma unroll
            for (int m = 0; m < 4; ++m) {
                const int nrow = u.pm * 256 + ai * 128 + wr * 64 + m * 16 + fr;
                bf16_t* base = vt + ((size_t)(b * nh + (nrow >> 6)) * 64 + (nrow & 63)) * 2048;
#pragma unroll
                for (int bj = 0; bj < 2; ++bj)
#pragma unroll
                    for (int n = 0; n < 2; ++n) {
                        const int rl0 = ((u.pn * 256) & 2047) + bj * 128 + wc * 32 + 16 * n;
                        const f32x4 v = acc[ai][bj][m][n] * rs[bj][n];
                        u32x2 w; w.x = cvtpk(v[0], v[1]); w.y = cvtpk(v[2], v[3]);
                        *(u32x2*)(base + rl0 + 4 * swap12(fq)) = w;
                    }
            }
    }
};

struct EpiRes {
    static constexpr bool PERM = true;
    bf16_t* out; float* part;
    __device__ __forceinline__ void operator()(const f32x4 (&acc)[2][2][4][2], const Unit& u, int wr, int wc, int fr, int fq) const {
#pragma unroll
        for (int ai = 0; ai < 2; ++ai)
#pragma unroll
            for (int m = 0; m < 4; ++m) {
                const int row = u.pm * 256 + ai * 128 + wr * 64 + m * 16 + fr;
                float ss = 0.f;
#pragma unroll
                for (int bj = 0; bj < 2; ++bj) {
                    const f32x4 v0 = acc[ai][bj][m][0], v1 = acc[ai][bj][m][1];
                    ss += (v0[0] * v0[0] + v0[1] * v0[1]) + (v0[2] * v0[2] + v0[3] * v0[3]) + (v1[0] * v1[0] + v1[1] * v1[1]) + (v1[2] * v1[2] + v1[3] * v1[3]);
                    *(u32x4*)(out + (size_t)row * 1024 + u.pn * 256 + bj * 128 + wc * 32 + 8 * fq) = pack8(v0, v1);
                }
                ss += __shfl_xor(ss, 16); ss += __shfl_xor(ss, 32);
                if (fq == 0) part[(size_t)row * 16 + u.pn * 4 + wc] = ss;
            }
    }
};

struct EpiGU {
    static constexpr bool PERM = true;
    bf16_t* act; const float* rstd;
    __device__ __forceinline__ void operator()(const f32x4 (&acc)[2][2][4][2], const Unit& u, int wr, int wc, int fr, int fq) const {
#pragma unroll
        for (int ai = 0; ai < 2; ++ai)
#pragma unroll
            for (int m = 0; m < 4; ++m) {
                const int row = u.pm * 256 + ai * 128 + wr * 64 + m * 16 + fr;
                const float rs = rstd[row];
                f32x4 o[2];
#pragma unroll
                for (int n = 0; n < 2; ++n) {
                    const f32x4 gg = acc[ai][0][m][n] * rs, uu = acc[ai][1][m][n] * rs;
#pragma unroll
                    for (int j = 0; j < 4; ++j) o[n][j] = gg[j] * __builtin_amdgcn_rcpf(1.f + __expf(-gg[j])) * uu[j];
                }
                *(u32x4*)(act + (size_t)row * DFF + u.pn * 128 + wc * 32 + 8 * fq) = pack8(o[0], o[1]);
            }
    }
};
}

#define MFMA32(a, b, c) __builtin_amdgcn_mfma_f32_32x32x16_bf16((a), (b), (c), 0, 0, 0)
__device__ __forceinline__ int crow(int reg, int hh) { return (reg & 3) + 8 * (reg >> 2) + 4 * hh; }
__device__ __forceinline__ bf16x8 ldg16(const bf16_t* p) { return *(const bf16x8*)p; }
#define PACK_STEP(x, s) __builtin_bit_cast(bf16x8, (u32x4){cvtpk((x)[8 * (s)], (x)[8 * (s) + 1]), cvtpk((x)[8 * (s) + 2], (x)[8 * (s) + 3]), cvtpk((x)[8 * (s) + 4], (x)[8 * (s) + 5]), cvtpk((x)[8 * (s) + 6], (x)[8 * (s) + 7])})

struct Att { f32x16 o0, o1; float m, l; };
__device__ __forceinline__ void att_init(Att& st) {
#pragma unroll
    for (int i = 0; i < 16; ++i) { st.o0[i] = 0.f; st.o1[i] = 0.f; }
    st.m = -INFINITY; st.l = 0.f;
}
template <class MaskF>
__device__ __forceinline__ void att_tile(Att& st, const bf16x8 (&qf)[4], const bf16_t* Kp, const bf16_t* Vp, int VS, int key0, MaskF valid, int r, int hh) {
    bf16x8 kf[4], vf[2][2];
#pragma unroll
    for (int ks = 0; ks < 4; ++ks) kf[ks] = ldg16(Kp + (size_t)(key0 + r) * 64 + 16 * ks + 8 * hh);
#pragma unroll
    for (int db = 0; db < 2; ++db)
#pragma unroll
        for (int s = 0; s < 2; ++s) vf[db][s] = ldg16(Vp + (size_t)(32 * db + r) * VS + key0 + 16 * s + 8 * hh);
    f32x16 s;
#pragma unroll
    for (int i = 0; i < 16; ++i) s[i] = 0.f;
#pragma unroll
    for (int ks = 0; ks < 4; ++ks) s = MFMA32(kf[ks], qf[ks], s);
    float mx = -INFINITY;
#pragma unroll
    for (int i = 0; i < 16; ++i) { s[i] = valid(crow(i, hh)) ? s[i] * SC_LOG2 : -INFINITY; mx = fmaxf(mx, s[i]); }
    mx = fmaxf(mx, __shfl_xor(mx, 32));
    const float mnew = fmaxf(st.m, mx);
    const float msafe = (mnew == -INFINITY) ? 0.f : mnew;
    const float alpha = __builtin_amdgcn_exp2f(st.m - msafe);
    float ps = 0.f;
#pragma unroll
    for (int i = 0; i < 16; ++i) { s[i] = __builtin_amdgcn_exp2f(s[i] - msafe); ps += s[i]; }
    st.l = st.l * alpha + ps; st.m = mnew;
#pragma unroll
    for (int i = 0; i < 16; ++i) { st.o0[i] *= alpha; st.o1[i] *= alpha; }
    const bf16x8 pb0 = PACK_STEP(s, 0), pb1 = PACK_STEP(s, 1);
    st.o0 = MFMA32(vf[0][0], pb0, st.o0); st.o0 = MFMA32(vf[0][1], pb1, st.o0);
    st.o1 = MFMA32(vf[1][0], pb0, st.o1); st.o1 = MFMA32(vf[1][1], pb1, st.o1);
}

constexpr int NWAVES = 8, NTHREADS = 512;
constexpr int LDS_BYTES = 147456;
constexpr int LDS_MISC = 131072;
struct Params { const float* in[17]; float* out; unsigned char* ws; int ph_lo, ph_hi; };

#define XB_TMO      128
#define XB_XCNT(j)  (256  + 64 * (j))
#define XB_XSUB(j)  (1280 + 64 * (j))
#define XB_XGEN(j)  (2304 + 64 * (j))
#define XB_TOP      3328
#define XB_TOPGEN   3392
#define XCD_BAR_WORDS 3456
#define XB_SPIN_CAP (1u << 22)
__device__ __forceinline__ unsigned xb_ld(unsigned* p)              { return __hip_atomic_load(p, __ATOMIC_RELAXED, __HIP_MEMORY_SCOPE_AGENT); }
__device__ __forceinline__ unsigned xb_add(unsigned* p, unsigned v) { return __hip_atomic_fetch_add(p, v, __ATOMIC_RELAXED, __HIP_MEMORY_SCOPE_AGENT); }
__device__ __forceinline__ unsigned xb_xcc_id() { return (unsigned)__builtin_amdgcn_s_getreg((3 << 11) | 20) & 0xFu; }
#define XB_SPIN(cond, bar) do { unsigned _sp = 0; while (cond) { __builtin_amdgcn_s_sleep(1); \
    if ((++_sp & 255u) == 0u) { if (xb_ld(&(bar)[XB_TMO])) break; if (_sp > XB_SPIN_CAP) { atomicAdd(&(bar)[XB_TMO], 1u); break; } } } } while (0)
struct XcdBarrier { unsigned* bar; unsigned x; volatile LAS unsigned* st; };
__device__ __forceinline__ XcdBarrier xcd_barrier_post(unsigned* bar, volatile LAS unsigned* st) {
    XcdBarrier b; b.bar = bar; b.x = xb_xcc_id(); b.st = st;
    if (threadIdx.x == 0) (void)xb_add(&bar[XB_XCNT(b.x)], 1u);
    return b;
}
__device__ __forceinline__ void xcd_barrier_complete(unsigned* bar, unsigned x, unsigned& nloc, unsigned& nx) {
    const unsigned G = gridDim.x * gridDim.y * gridDim.z;
    unsigned sum, cnt, mine, sp = 0u;
    for (;;) {
        sum = 0u; cnt = 0u; mine = 0u;
#pragma unroll
        for (unsigned j = 0; j < 16; ++j) { const unsigned c = xb_ld(&bar[XB_XCNT(j)]); sum += c; cnt += (c > 0u) ? 1u : 0u; mine = (j == x) ? c : mine; }
        if (sum == G) break;
        __builtin_amdgcn_s_sleep(1);
        if ((++sp & 255u) == 0u) { if (xb_ld(&bar[XB_TMO])) break; if (sp > XB_SPIN_CAP) { atomicAdd(&bar[XB_TMO], 1u); break; } }
    }
    nloc = mine > 0u ? mine : 1u; nx = cnt > 0u ? cnt : 1u;
}
__device__ __forceinline__ void xcd_barrier(const XcdBarrier& b) {
    asm volatile("s_waitcnt vmcnt(0)" ::: "memory");
    __syncthreads();
    if (threadIdx.x == 0) {
        unsigned* bar = b.bar;
        __builtin_amdgcn_s_waitcnt(0);
        unsigned nloc = b.st[0], nx = b.st[1];
        if (nloc == 0u) { xcd_barrier_complete(bar, b.x, nloc, nx); b.st[0] = nloc; b.st[1] = nx; }
        const unsigned old = xb_add(&bar[XB_XSUB(b.x)], 1u);
        const unsigned gen = old / nloc;
        if (old + 1u == (gen + 1u) * nloc) {
            __builtin_amdgcn_fence(__ATOMIC_RELEASE, "agent");
            asm volatile("s_waitcnt vmcnt(0)" ::: "memory");
            const unsigned og = xb_add(&bar[XB_TOP], 1u);
            const unsigned tg = og / nx;
            if (og + 1u == (tg + 1u) * nx) xb_add(&bar[XB_TOPGEN], 1u);
            else XB_SPIN(xb_ld(&bar[XB_TOPGEN]) == tg, bar);
            __builtin_amdgcn_fence(__ATOMIC_ACQUIRE, "agent");
            xb_add(&bar[XB_XGEN(b.x)], 1u);
            asm volatile("s_waitcnt vmcnt(0)" ::: "memory");
        } else {
            XB_SPIN(xb_ld(&bar[XB_XGEN(b.x)]) == gen, bar);
            __builtin_amdgcn_fence(__ATOMIC_ACQUIRE, "agent");
            asm volatile("s_waitcnt vmcnt(0)" ::: "memory");
        }
    }
    __syncthreads();
}

__device__ __forceinline__ unsigned f2bf(float f) { unsigned u = __builtin_bit_cast(unsigned, f); return (u + 0x7fffu + ((u >> 16) & 1u)) >> 16; }
__device__ __forceinline__ unsigned pk2(float lo, float hi) { return f2bf(lo) | (f2bf(hi) << 16); }
__device__ __forceinline__ void conv_item(const float* src, int Nsrc, int K, bf16_t* dst, int r0, int c0, int nvalid, const float* gain, int k0, LAS float* scr, int lane) {
#pragma unroll 8
    for (int i = 0; i < 32; ++i) { const int kk = 2 * i + (lane >> 5), n = lane & 31;
        float v = 0.f; if (n < nvalid) { v = src[(size_t)(k0 + kk) * Nsrc + c0 + n]; if (gain) v *= gain[k0 + kk]; }
        scr[kk * 33 + n] = v; }
    asm volatile("s_waitcnt lgkmcnt(0)" ::: "memory");
    const int c = lane & 7;
#pragma unroll
    for (int j = 0; j < 4; ++j) { const int n = (lane >> 3) + 8 * j; const LAS float* s = scr + (8 * c) * 33 + n;
        u32x4 o; o.x = pk2(s[0 * 33], s[1 * 33]); o.y = pk2(s[2 * 33], s[3 * 33]); o.z = pk2(s[4 * 33], s[5 * 33]); o.w = pk2(s[6 * 33], s[7 * 33]);
        *(u32x4*)(dst + (size_t)(r0 + n) * K + k0 + 8 * c) = o; }
    asm volatile("s_waitcnt lgkmcnt(0)" ::: "memory");
}

__global__ void __launch_bounds__(NTHREADS, 2) trunk_fwd(Params P) {
    extern __shared__ __attribute__((aligned(16))) unsigned char lds_raw[];
    LAS unsigned char* lds = (LAS unsigned char*)lds_raw;
    volatile LAS unsigned* MISC = (volatile LAS unsigned*)(lds + LDS_MISC);
    const int G = gridDim.x, bx = blockIdx.x;
    const int NGW = G * NWAVES;
    if (threadIdx.x < 64) MISC[threadIdx.x] = 0u;
    __syncthreads();
#if MK_ONE_LAUNCH
    XcdBarrier bar = xcd_barrier_post((unsigned*)(P.ws + WS_CTL) + 4096, MISC + 8);
    bool first_bar = true;
#define GRID_BAR() do { if (first_bar) { cooperative_groups::this_grid().sync(); first_bar = false; } xcd_barrier(bar); } while (0)
#else
#define GRID_BAR() do { } while (0)
#endif
    const int lo = P.ph_lo, hi = P.ph_hi;
    int ph = 0;
typedef const Params __attribute__((address_space(4)))* KParams;
#define PHASE_BEGIN if (ph >= lo && ph < hi) { int tid = threadIdx.x; asm volatile("" : "+v"(tid)); const int lane = tid & 63; const int wave = __builtin_amdgcn_readfirstlane(tid >> 6); const int gw = bx * NWAVES + wave; (void)lane; (void)gw; \
    KParams PP = (KParams)__builtin_amdgcn_kernarg_segment_ptr(); asm volatile("" : "+s"(PP)); unsigned char* ws = PP->ws; \
    const float* x = PP->in[0]; const int* positions = (const int*)PP->in[1]; \
    const float *g_mix_pre = PP->in[2], *g_mix_post = PP->in[3], *g_ffn_pre = PP->in[4], *g_ffn_post = PP->in[5]; \
    const float *w_gu = PP->in[6], *w_down = PP->in[7], *nsa_w_in = PP->in[8], *nsa_cmp_pos = PP->in[9]; \
    const float *cmp_wk1 = PP->in[10], *cmp_wk2 = PP->in[11], *cmp_wv1 = PP->in[12], *cmp_wv2 = PP->in[13], *nsa_w_o = PP->in[14], *dil_w_in = PP->in[15], *dil_w_o = PP->in[16]; \
    float* hout = PP->out; \
    float* rcos = (float*)(ws + WS_ROPE); float* rsin = rcos + MTOK * 8; \
    float* rstd = (float*)(ws + WS_RSTD); float* bias1 = (float*)(ws + WS_BIAS1); float* part = (float*)(ws + WS_PART); float* lse = (float*)(ws + WS_LSE); \
    bf16_t* Wgu = (bf16_t*)(ws + WS_WGU); bf16_t* Wdn = (bf16_t*)(ws + WS_WDN); bf16_t* Wni = (bf16_t*)(ws + WS_WNI); bf16_t* Wno = (bf16_t*)(ws + WS_WNO); \
    bf16_t* Wdi = (bf16_t*)(ws + WS_WDI); bf16_t* Wdo = (bf16_t*)(ws + WS_WDO); bf16_t* Wc1 = (bf16_t*)(ws + WS_WC1); bf16_t* Wc2 = (bf16_t*)(ws + WS_WC2); \
    bf16_t* HB = (bf16_t*)(ws + WS_HB); \
    bf16_t* ACT = (bf16_t*)(ws + S_ACT); bf16_t* OB = (bf16_t*)(ws + S_O); bf16_t* MB = (bf16_t*)(ws + S_M); \
    bf16_t* QP = (bf16_t*)(ws + S_QP); bf16_t* QR = (bf16_t*)(ws + S_QR); bf16_t* KCMP = (bf16_t*)(ws + S_KCMP); bf16_t* VCMP = (bf16_t*)(ws + S_VCMP); \
    bf16_t* KSEL = (bf16_t*)(ws + S_KSEL); bf16_t* KWIN = (bf16_t*)(ws + S_KWIN); bf16_t* VT = (bf16_t*)(ws + S_VT); float* GATES = (float*)(ws + S_GATES); \
    bf16_t* KC = (bf16_t*)(ws + S_KC); bf16_t* VCT = (bf16_t*)(ws + S_VCT); \
    bf16_t* DQ = (bf16_t*)(ws + S_DQ); bf16_t* DK = (bf16_t*)(ws + S_DK); bf16_t* DV = (bf16_t*)(ws + S_DV); \
    (void)x; (void)positions; (void)g_mix_pre; (void)g_mix_post; (void)g_ffn_pre; (void)g_ffn_post; (void)w_gu; (void)w_down; (void)nsa_w_in; (void)nsa_cmp_pos; (void)cmp_wk1; (void)cmp_wk2; (void)cmp_wv1; (void)cmp_wv2; \
    (void)nsa_w_o; (void)dil_w_in; (void)dil_w_o; (void)hout; (void)rcos; (void)rsin; (void)rstd; (void)bias1; (void)part; (void)lse; (void)Wgu; (void)Wdn; (void)Wni; (void)Wno; (void)Wdi; (void)Wdo; (void)Wc1; (void)Wc2; (void)HB; \
    (void)ACT; (void)OB; (void)MB; (void)QP; (void)QR; (void)KCMP; (void)VCMP; (void)KSEL; (void)KWIN; (void)VT; (void)GATES; (void)KC; (void)VCT; (void)DQ; (void)DK; (void)DV;
#define PHASE_END   if (ph + 1 < hi) GRID_BAR(); } ++ph;

    PHASE_BEGIN
    {
        LAS float* scr = (LAS float*)(lds + wave * 16384);
        constexpr int I_GU = 16 * 176, I_DN = 44 * 32, I_NI = 16 * 88, I_NO = 16 * 32, I_DI = 16 * 288, I_C1 = 32 * 8, I_C2 = 4 * 2;
        constexpr int NITEMS = 4 * I_GU + 4 * I_DN + 2 * I_NI + 2 * I_NO + 2 * I_DI + 2 * I_NO + 4 * I_C1 + 4 * I_C2;
        for (int it0 = gw; it0 < NITEMS; it0 += NGW) {
            int it = it0;
            if (it < 4 * I_GU) { const int L = it / I_GU, r = it % I_GU, kb = r / 176, nb = r % 176;
                const int pn = nb >> 3, wh = (nb >> 2) & 1, j0 = (nb & 3) * 32;
                conv_item(w_gu + (size_t)L * 1024 * 5632, 5632, 1024, Wgu + (size_t)L * 5632 * 1024, nb * 32, wh * DFF + pn * 128 + j0, 32, g_ffn_pre + L * 1024, kb * 64, scr, lane); continue; }
            it -= 4 * I_GU;
            if (it < 4 * I_DN) { const int L = it / I_DN, r = it % I_DN, kb = r / 32, nb = r % 32;
                conv_item(w_down + (size_t)L * DFF * 1024, 1024, DFF, Wdn + (size_t)L * 1024 * DFF, nb * 32, nb * 32, 32, nullptr, kb * 64, scr, lane); continue; }
            it -= 4 * I_DN;
            if (it < 2 * I_NI) { const int L = it / I_NI, r = it % I_NI, kb = r / 88, nb = r % 88; const int r0 = nb * 32;
                int c0, nv = 32;
                if (r0 < 1792) c0 = r0;
                else if (r0 < 2048) c0 = 2048 + (r0 - 1792);
                else if (r0 < 2304) { c0 = 2560 + (r0 - 2048); nv = (r0 - 2048) < 32 ? 32 : ((r0 - 2048) < 64 ? 16 : 0); if (nv == 0) c0 = 0; }
                else if (r0 < 2560) c0 = 1792 + (r0 - 2304);
                else c0 = 2304 + (r0 - 2560);
                conv_item(nsa_w_in + (size_t)L * 1024 * NSA_IN, NSA_IN, 1024, Wni + (size_t)L * NSA_INP * 1024, r0, c0, nv, g_mix_pre + (2 * L) * 1024, kb * 64, scr, lane); continue; }
            it -= 2 * I_NI;
            if (it < 2 * I_NO) { const int L = it / I_NO, r = it % I_NO, kb = r / 32, nb = r % 32;
                conv_item(nsa_w_o + (size_t)L * 1024 * 1024, 1024, 1024, Wno + (size_t)L * 1024 * 1024, nb * 32, nb * 32, 32, nullptr, kb * 64, scr, lane); continue; }
            it -= 2 * I_NO;
            if (it < 2 * I_DI) { const int L = it / I_DI, r = it % I_DI, kb = r / 288, nb = r % 288;
                conv_item(dil_w_in + (size_t)L * 1024 * DIL_IN, DIL_IN, 1024, Wdi + (size_t)L * DIL_IN * 1024, nb * 32, nb * 32, 32, g_mix_pre + (2 * L + 1) * 1024, kb * 64, scr, lane); continue; }
            it -= 2 * I_DI;
            if (it < 2 * I_NO) { const int L = it / I_NO, r = it % I_NO, kb = r / 32, nb = r % 32;
                conv_item(dil_w_o + (size_t)L * 1024 * 1024, 1024, 1024, Wdo + (size_t)L * 1024 * 1024, nb * 32, nb * 32, 32, nullptr, kb * 64, scr, lane); continue; }
            it -= 2 * I_NO;
            if (it < 4 * I_C1) { const int LW = it / I_C1, r = it % I_C1, kb = r / 8, nb = r % 8; const int L = LW >> 1, wh = LW & 1;
                conv_item((wh ? cmp_wv1 : cmp_wk1) + (size_t)L * 2048 * 256, 256, 2048, Wc1 + (size_t)LW * 256 * 2048, nb * 32, nb * 32, 32, nullptr, kb * 64, scr, lane); continue; }
            it -= 4 * I_C1;
            { const int LW = it / I_C2, r = it % I_C2, kb = r / 2, nb = r % 2; const int L = LW >> 1, wh = LW & 1;
                conv_item((wh ? cmp_wv2 : cmp_wk2) + (size_t)L * 256 * 64, 64, 256, Wc2 + (size_t)LW * 64 * 256, nb * 32, nb * 32, 32, nullptr, kb * 64, scr, lane); }
        }
        for (int m = gw; m < MTOK; m += NGW) {
            const f32x4* xr = (const f32x4*)(x + (size_t)m * DM) + lane;
            f32x4 v[4]; float s = 0.f;
#pragma unroll
            for (int j = 0; j < 4; ++j) { v[j] = xr[64 * j]; s += (v[j][0] * v[j][0] + v[j][1] * v[j][1]) + (v[j][2] * v[j][2] + v[j][3] * v[j][3]); }
            s = wave_sum(s);
            u32x2* o8 = (u32x2*)(HB + (size_t)m * DM) + lane;
#pragma unroll
            for (int j = 0; j < 4; ++j) { u32x2 w; w.x = cvtpk(v[j][0], v[j][1]); w.y = cvtpk(v[j][2], v[j][3]); o8[64 * j] = w; }
            if (lane == 0) rstd[m] = 1.0f / sqrtf(s * (1.0f / DM) + NORM_EPS);
            if (lane < 8) {
                const float inv = exp2f(-(float)lane * (1.0f / 8.0f) * 18.931568569324174f);
                const float ang = (float)positions[m] * inv;
                const double rev = (double)ang * 0.15915494309189535; const double fr = rev - __builtin_rint(rev);
                rcos[(size_t)m * 8 + lane] = __builtin_amdgcn_cosf((float)fr); rsin[(size_t)m * 8 + lane] = __builtin_amdgcn_sinf((float)fr);
            }
        }
        for (int o = bx * NTHREADS + tid; o < 2 * 2 * 256; o += G * NTHREADS) {
            const int j = o & 255, LW = o >> 8, L = LW >> 1, wh = LW & 1;
            const float* w1 = (wh ? cmp_wv1 : cmp_wk1) + (size_t)L * 2048 * 256; const float* pp = nsa_cmp_pos + (size_t)L * 2048;
            float s = 0.f; for (int k = 0; k < 2048; ++k) s += pp[k] * w1[(size_t)k * 256 + j];
            bias1[o] = s;
        }
    }
    PHASE_END

    for (int layer = 0; layer < DEPTH; ++layer) {
        const int lj = layer >> 1;
        if ((layer & 1) == 0) {
            PHASE_BEGIN
            {
                const bf16_t* W = Wni + (size_t)lj * NSA_INP * 1024;
                { pg8::Gemm g{{HB, 1024, 1}, {W, 1024, 1}, MTOK, 2304, 1024}; pg8::StaticOrder S; S.init(MTOK, 2304, G, bx);
                  pg8::EpiProj E{0, 1, rstd, rcos, rsin, QP, QR, KCMP, VCMP, KSEL, KWIN, GATES};
                  pg8::gemm_phase<pg8::EpiProj, pg8::StaticOrder>(lds, g, S, E); }
                { pg8::Gemm g{{W + (size_t)2304 * 1024, 1024, 1}, {HB, 1024, 1}, 512, MTOK, 1024}; pg8::StaticOrder S; S.init(512, MTOK, G, (bx + G - (576 % G)) % G);
                  pg8::EpiVT E{VT, 8, 1, rstd};
                  pg8::gemm_phase<pg8::EpiVT, pg8::StaticOrder>(lds, g, S, E); }
            }
            PHASE_END
            PHASE_BEGIN
            {
                LAS bf16_t* hid = (LAS bf16_t*)lds;
                const int r16 = lane & 15, q4 = lane >> 4;
                for (int item = bx; item < 128; item += G) {
                    const int wh = item >> 6, rt = item & 63;
                    const bf16_t* A = (wh ? VCMP : KCMP) + (size_t)rt * 64 * 1024;
                    const bf16_t* W1 = Wc1 + (size_t)(lj * 2 + wh) * 256 * 2048;
                    const bf16_t* W2 = Wc2 + (size_t)(lj * 2 + wh) * 64 * 256;
                    const float* b1 = bias1 + (lj * 2 + wh) * 256;
                    f32x4 acc[4][2];
#pragma unroll
                    for (int i = 0; i < 4; ++i) { acc[i][0] = (f32x4){0.f, 0.f, 0.f, 0.f}; acc[i][1] = acc[i][0]; }
                    const bf16_t* ap = A + (size_t)r16 * 1024 + 8 * q4;
                    const bf16_t* bp = W1 + (size_t)(wave * 32 + r16) * 2048 + 8 * q4;
#pragma unroll 2
                    for (int k0 = 0; k0 < 2048; k0 += 32) {
                        bf16x8 af[4], bfr[2];
#pragma unroll
                        for (int i = 0; i < 4; ++i) af[i] = ldg16(ap + (size_t)i * 16 * 1024 + k0);
#pragma unroll
                        for (int j = 0; j < 2; ++j) bfr[j] = ldg16(bp + (size_t)j * 16 * 2048 + k0);
#pragma unroll
                        for (int i = 0; i < 4; ++i)
#pragma unroll
                            for (int j = 0; j < 2; ++j) acc[i][j] = __builtin_amdgcn_mfma_f32_16x16x32_bf16(af[i], bfr[j], acc[i][j], 0, 0, 0);
                    }
#pragma unroll
                    for (int i = 0; i < 4; ++i)
#pragma unroll
                        for (int j = 0; j < 2; ++j) { const int col = wave * 32 + j * 16 + r16; const float bb = b1[col];
#pragma unroll
                            for (int e = 0; e < 4; ++e) { float v = acc[i][j][e] + bb; v = v / (1.f + __expf(-v)); hid[(i * 16 + 4 * q4 + e) * 264 + col] = (bf16_t)f2bf(v); } }
                    __syncthreads();
                    const int rb = wave >> 1, cb0 = (wave & 1) * 2;
                    f32x4 o2[2] = {(f32x4){0.f, 0.f, 0.f, 0.f}, (f32x4){0.f, 0.f, 0.f, 0.f}};
#pragma unroll
                    for (int k0 = 0; k0 < 256; k0 += 32) {
                        const bf16x8 hf = *(const LAS bf16x8*)(hid + (rb * 16 + r16) * 264 + k0 + 8 * q4);
#pragma unroll
                        for (int j = 0; j < 2; ++j) { const bf16x8 wf = ldg16(W2 + (size_t)((cb0 + j) * 16 + r16) * 256 + k0 + 8 * q4);
                            if (wh == 0) o2[j] = __builtin_amdgcn_mfma_f32_16x16x32_bf16(wf, hf, o2[j], 0, 0, 0);
                            else         o2[j] = __builtin_amdgcn_mfma_f32_16x16x32_bf16(hf, wf, o2[j], 0, 0, 0); }
                    }
#pragma unroll
                    for (int j = 0; j < 2; ++j) {
                        u32x2 w; w.x = cvtpk(o2[j][0], o2[j][1]); w.y = cvtpk(o2[j][2], o2[j][3]);
                        if (wh == 0) { const int R = rt * 64 + rb * 16 + r16; *(u32x2*)(KC + (size_t)R * 64 + (cb0 + j) * 16 + 4 * q4) = w; }
                        else { const int R0 = rt * 64 + rb * 16, bh = R0 >> 7, c0 = R0 & 127, d = (cb0 + j) * 16 + r16;
                               *(u32x2*)(VCT + ((size_t)bh * 64 + d) * 128 + c0 + 4 * swap12(q4)) = w; }
                    }
                    __syncthreads();
                }
            }
            PHASE_END
            PHASE_BEGIN
            {
                LAS float* impL = (LAS float*)lds;
                LAS unsigned* selm = (LAS unsigned*)(lds + 4 * 64 * 33 * 4);
                for (int idx = bx; idx < 1024; idx += G) {
                    int ln = lane; asm volatile("" : "+v"(ln)); const int r = ln & 31, hh = ln >> 5;
                    const int kr = idx >> 8, wv = idx & 255, chl = wv & 31, ch = (kr & 1) ? 31 - chl : chl, bh = kr * 8 + (wv >> 5), b = bh >> 2, hk = bh & 3;
                    const int g = wave & 3, qh = wave >> 2, h = hk * 4 + g;
                    const int q0 = ch * 64 + qh * 32, t = q0 + r;
                    const size_t tokg = (size_t)b * 2048 + t;
                    bf16x8 qfp[4];
                    { const bf16_t* qp = QP + ((size_t)(b * 16 + h) * 2048 + t) * 64 + 8 * hh;
#pragma unroll
                      for (int ks = 0; ks < 4; ++ks) qfp[ks] = ldg16(qp + 16 * ks); }
                    const float gc = GATES[tokg * 48 + h], gs = GATES[tokg * 48 + 16 + h], gwn = GATES[tokg * 48 + 32 + h];
                    f32x16 cmb0, cmb1;
                    {
                        const bf16_t* Kc = KC + (size_t)bh * 128 * 64; const bf16_t* Vc = VCT + (size_t)bh * 64 * 128;
                        const int ktmax = q0 >> 9;
                        f32x16 sc[4];
#pragma unroll
                        for (int kt = 0; kt < 4; ++kt) {
#pragma unroll
                            for (int i = 0; i < 16; ++i) sc[kt][i] = 0.f;
                            if (kt <= ktmax) {
#pragma unroll
                                for (int ks = 0; ks < 4; ++ks) sc[kt] = MFMA32(ldg16(Kc + (size_t)(32 * kt + r) * 64 + 16 * ks + 8 * hh), qfp[ks], sc[kt]);
                            }
                        }
                        float mx = -INFINITY;
#pragma unroll
                        for (int kt = 0; kt < 4; ++kt)
#pragma unroll
                            for (int i = 0; i < 16; ++i) { const int c = 32 * kt + crow(i, hh); const bool v = (kt <= ktmax) && (16 * c + 31 <= t);
                                sc[kt][i] = v ? sc[kt][i] * SC_LOG2 : -INFINITY; mx = fmaxf(mx, sc[kt][i]); }
                        mx = fmaxf(mx, __shfl_xor(mx, 32));
                        const float msafe = (mx == -INFINITY) ? 0.f : mx;
                        float ls = 0.f;
#pragma unroll
                        for (int kt = 0; kt < 4; ++kt)
#pragma unroll
                            for (int i = 0; i < 16; ++i) { sc[kt][i] = __builtin_amdgcn_exp2f(sc[kt][i] - msafe); ls += sc[kt][i]; }
                        ls += __shfl_xor(ls, 32);
                        const float inv = ls > 0.f ? 1.0f / ls : 0.f;
                        f32x16 o0, o1;
#pragma unroll
                        for (int i = 0; i < 16; ++i) { o0[i] = 0.f; o1[i] = 0.f; }
#pragma unroll
                        for (int kt = 0; kt < 4; ++kt) if (kt <= ktmax) {
                            const bf16x8 pb0 = PACK_STEP(sc[kt], 0), pb1 = PACK_STEP(sc[kt], 1);
                            o0 = MFMA32(ldg16(Vc + (size_t)r * 128 + 32 * kt + 8 * hh), pb0, o0); o0 = MFMA32(ldg16(Vc + (size_t)r * 128 + 32 * kt + 16 + 8 * hh), pb1, o0);
                            o1 = MFMA32(ldg16(Vc + (size_t)(32 + r) * 128 + 32 * kt + 8 * hh), pb0, o1); o1 = MFMA32(ldg16(Vc + (size_t)(32 + r) * 128 + 32 * kt + 16 + 8 * hh), pb1, o1);
                        }
                        const float f = inv * gc;
#pragma unroll
                        for (int i = 0; i < 16; ++i) { cmb0[i] = o0[i] * f; cmb1[i] = o1[i] * f; }
                        float recv_prev = 0.f;
                        LAS float* row = impL + ((g * 64) + 32 * qh + r) * 33;
#pragma unroll
                        for (int kt = 0; kt < 4; ++kt)
#pragma unroll
                            for (int rg = 0; rg < 4; ++rg) {
                                const float a0 = sc[kt][4 * rg] * inv, a1 = sc[kt][4 * rg + 1] * inv, a2 = sc[kt][4 * rg + 2] * inv, a3 = sc[kt][4 * rg + 3] * inv;
                                const float recv = __shfl_xor(a3, 32);
                                row[8 * kt + 2 * rg + hh] = ((a0 + a1) + (a2 + a3)) + (hh ? recv : recv_prev);
                                recv_prev = recv;
                            }
                    }
                    __syncthreads();
                    if (tid < 64) {
                        LAS float* r0 = impL + tid * 33;
                        for (int j = 0; j < 32; ++j) {
                            const float s = ((r0[j] + r0[64 * 33 + j]) + r0[2 * 64 * 33 + j]) + r0[3 * 64 * 33 + j];
                            const bool forced = (j == 0) || (j == ch) || (j == ch - 1);
                            r0[j] = forced ? 1e4f : (j <= ch ? s : -1.0f);
                        }
                        unsigned sel = 0u;
                        for (int rnd = 0; rnd < 8; ++rnd) { float best = -2.0f; int bi = 0;
                            for (int j = 0; j < 32; ++j) { const float v = r0[j]; if (!((sel >> j) & 1u) && v > best) { best = v; bi = j; } }
                            sel |= 1u << bi; }
                        sel &= (ch >= 31) ? 0xffffffffu : ((2u << ch) - 1u);
                        selm[tid] = sel;
                        unsigned un = sel;
#pragma unroll
                        for (int o = 1; o < 64; o <<= 1) un |= __shfl_xor(un, o);
                        if (tid == 0) selm[64] = un;
                    }
                    __syncthreads();
                    bf16x8 qfr[4];
                    { const bf16_t* qr = QR + ((size_t)(b * 16 + h) * 2048 + t) * 64 + 8 * hh;
#pragma unroll
                      for (int ks = 0; ks < 4; ++ks) qfr[ks] = ldg16(qr + 16 * ks); }
                    const unsigned mymask = selm[32 * qh + r];
                    const unsigned un = __builtin_amdgcn_readfirstlane(selm[64]);
                    {
                        Att st; att_init(st);
                        const bf16_t* Ks = KSEL + (size_t)bh * 2048 * 64; const bf16_t* Vs = VT + (size_t)(b * 8 + hk) * 64 * 2048;
                        for (unsigned rem = un; rem; rem &= rem - 1u) {
                            const int j = __builtin_ctz(rem);
                            const bool mine = (mymask >> j) & 1u;
                            if (__ballot(mine) == 0ull) continue;
                            for (int kt2 = 0; kt2 < 2; ++kt2) { const int key0 = 64 * j + 32 * kt2; if (key0 > q0 + 31) continue;
                                att_tile(st, qfr, Ks, Vs, 2048, key0, [&](int rw) { return mine && (key0 + rw <= t); }, r, hh); }
                        }
                        const float lt = st.l + __shfl_xor(st.l, 32); const float f = (lt > 0.f ? 1.0f / lt : 0.f) * gs;
#pragma unroll
                        for (int i = 0; i < 16; ++i) { cmb0[i] += st.o0[i] * f; cmb1[i] += st.o1[i] * f; }
                    }
                    {
                        Att st; att_init(st);
                        const bf16_t* Kw = KWIN + (size_t)bh * 2048 * 64; const bf16_t* Vw = VT + (size_t)(b * 8 + 4 + hk) * 64 * 2048;
                        for (int j = (ch > 8 ? ch - 8 : 0); j <= ch; ++j)
                            for (int kt2 = 0; kt2 < 2; ++kt2) { const int key0 = 64 * j + 32 * kt2; if (key0 > q0 + 31 || key0 + 31 < q0 - 511) continue;
                                att_tile(st, qfr, Kw, Vw, 2048, key0, [&](int rw) { const int key = key0 + rw; return key <= t && t - key <= 511; }, r, hh); }
                        const float lt = st.l + __shfl_xor(st.l, 32); const float f = (lt > 0.f ? 1.0f / lt : 0.f) * gwn;
#pragma unroll
                        for (int i = 0; i < 16; ++i) { cmb0[i] += st.o0[i] * f; cmb1[i] += st.o1[i] * f; }
                    }
                    { bf16_t* op = OB + tokg * 1024 + h * 64 + 4 * hh;
#pragma unroll
                      for (int rg = 0; rg < 4; ++rg) { u32x2 w0, w1; w0.x = cvtpk(cmb0[4 * rg], cmb0[4 * rg + 1]); w0.y = cvtpk(cmb0[4 * rg + 2], cmb0[4 * rg + 3]);
                          w1.x = cvtpk(cmb1[4 * rg], cmb1[4 * rg + 1]); w1.y = cvtpk(cmb1[4 * rg + 2], cmb1[4 * rg + 3]);
                          *(u32x2*)(op + 8 * rg) = w0; *(u32x2*)(op + 32 + 8 * rg) = w1; } }
                    __syncthreads();
                }
            }
            PHASE_END
        } else {
            for (int gi = 0; gi < 3; ++gi) {
                const int dil = gi == 0 ? 1 : (gi == 1 ? 4 : 16);
                PHASE_BEGIN
                {
                    bf16_t* DQg = DQ + (size_t)gi * MTOK * 1024;
                    const bf16_t* W = Wdi + (size_t)lj * DIL_IN * 1024 + (size_t)gi * 3072 * 1024;
                    { pg8::Gemm g{{HB, 1024, dil}, {W, 1024, 1}, MTOK, 2048, 1024}; pg8::StaticOrder S; S.init(MTOK, 2048, G, bx);
                      pg8::EpiProj E{1, dil, rstd, rcos, rsin, DQg, DK, nullptr, nullptr, nullptr, nullptr, nullptr};
                      pg8::gemm_phase<pg8::EpiProj, pg8::StaticOrder>(lds, g, S, E); }
                    { pg8::Gemm g{{W + (size_t)2048 * 1024, 1024, 1}, {HB, 1024, dil}, 1024, MTOK, 1024}; pg8::StaticOrder S; S.init(1024, MTOK, G, bx);
                      pg8::EpiVT E{DV, 16, dil, rstd};
                      pg8::gemm_phase<pg8::EpiVT, pg8::StaticOrder>(lds, g, S, E); }
                }
                PHASE_END
                PHASE_BEGIN
                {
                    bf16_t* DQg = DQ + (size_t)gi * MTOK * 1024;
                    const int r = lane & 31, hh = lane >> 5;
                    const int L = 2048 / dil;
                    for (int idx = bx; idx < 1024; idx += G) {
                        const int rg8 = idx & 7, h = (idx >> 3) & 15, b = idx >> 7;
                        const int rl0 = 256 * rg8 + 32 * wave, q = rl0 + r;
                        const int seq0 = rl0 & ~(L - 1);
                        const size_t hb = (size_t)(b * 16 + h);
                        bf16x8 qf[4];
                        { const bf16_t* qp = DQg + (hb * 2048 + q) * 64 + 8 * hh;
#pragma unroll
                          for (int ks = 0; ks < 4; ++ks) qf[ks] = ldg16(qp + 16 * ks); }
                        Att st; att_init(st);
                        const bf16_t* Kp = DK + hb * 2048 * 64; const bf16_t* Vp = DV + hb * 64 * 2048;
                        for (int key0 = (rl0 - 128 > seq0 ? rl0 - 128 : seq0); key0 <= rl0; key0 += 32)
                            att_tile(st, qf, Kp, Vp, 2048, key0, [&](int rw) { const int key = key0 + rw; return key <= q && q - key <= 128; }, r, hh);
                        const float lt = st.l + __shfl_xor(st.l, 32); const float inv = 1.0f / lt;
                        bf16_t* op = DQg + (hb * 2048 + q) * 64 + 4 * hh;
#pragma unroll
                        for (int rg = 0; rg < 4; ++rg) { u32x2 w0, w1; w0.x = cvtpk(st.o0[4 * rg] * inv, st.o0[4 * rg + 1] * inv); w0.y = cvtpk(st.o0[4 * rg + 2] * inv, st.o0[4 * rg + 3] * inv);
                            w1.x = cvtpk(st.o1[4 * rg] * inv, st.o1[4 * rg + 1] * inv); w1.y = cvtpk(st.o1[4 * rg + 2] * inv, st.o1[4 * rg + 3] * inv);
                            *(u32x2*)(op + 8 * rg) = w0; *(u32x2*)(op + 32 + 8 * rg) = w1; }
                        if (hh == 0) lse[((size_t)gi * 128 + hb) * 2048 + q] = st.m * 0.6931471805599453f + __logf(lt);
                    }
                }
                PHASE_END
            }
            PHASE_BEGIN
            {
                const int sub = lane >> 3, dl = (lane & 7) * 8;
                for (int it = gw; it < MTOK * 2; it += NGW) {
                    const int tok = it >> 1, h = (it & 1) * 8 + sub, b = tok >> 11, s = tok & 2047;
                    const size_t hb = (size_t)(b * 16 + h);
                    const int rl1 = (s & 3) * 512 + (s >> 2), rl2 = (s & 15) * 128 + (s >> 4);
                    const float l0 = lse[hb * 2048 + s], l1 = lse[((size_t)128 + hb) * 2048 + rl1], l2 = lse[((size_t)256 + hb) * 2048 + rl2];
                    const float mx = fmaxf(l0, fmaxf(l1, l2));
                    float e0 = __expf(l0 - mx), e1 = __expf(l1 - mx), e2 = __expf(l2 - mx); const float inv = 1.0f / (e0 + e1 + e2); e0 *= inv; e1 *= inv; e2 *= inv;
                    const u32x4 a = *(const u32x4*)(DQ + (hb * 2048 + s) * 64 + dl);
                    const u32x4 c = *(const u32x4*)(DQ + (size_t)MTOK * 1024 + (hb * 2048 + rl1) * 64 + dl);
                    const u32x4 d = *(const u32x4*)(DQ + (size_t)2 * MTOK * 1024 + (hb * 2048 + rl2) * 64 + dl);
                    u32x4 o;
#pragma unroll
                    for (int j = 0; j < 4; ++j) o[j] = cvtpk(bflo(a[j]) * e0 + bflo(c[j]) * e1 + bflo(d[j]) * e2, bfhi(a[j]) * e0 + bfhi(c[j]) * e1 + bfhi(d[j]) * e2);
                    *(u32x4*)(OB + (size_t)tok * 1024 + h * 64 + dl) = o;
                }
            }
            PHASE_END
        }
        PHASE_BEGIN
        {
            const bf16_t* W = ((layer & 1) ? Wdo : Wno) + (size_t)lj * 1024 * 1024;
            pg8::Gemm g{{OB, 1024, 1}, {W, 1024, 1}, MTOK, 1024, 1024}; pg8::StaticOrder S; S.init(MTOK, 1024, G, bx);
            pg8::EpiRes E{MB, part};
            pg8::gemm_phase<pg8::EpiRes, pg8::StaticOrder>(lds, g, S, E);
        }
        PHASE_END
        for (int half = 0; half < 2; ++half) {
            if (half == 1) {
                PHASE_BEGIN
                {
                    pg8::Gemm g{{HB, 1024, 1}, {Wgu + (size_t)layer * 5632 * 1024, 1024, 1}, MTOK, 5632, 1024}; pg8::StaticOrder S; S.init(MTOK, 5632, G, bx);
                    pg8::EpiGU E{ACT, rstd};
                    pg8::gemm_phase<pg8::EpiGU, pg8::StaticOrder>(lds, g, S, E);
                }
                PHASE_END
                PHASE_BEGIN
                {
                    pg8::Gemm g{{ACT, DFF, 1}, {Wdn + (size_t)layer * 1024 * DFF, DFF, 1}, MTOK, 1024, DFF}; pg8::StaticOrder S; S.init(MTOK, 1024, G, bx);
                    pg8::EpiRes E{MB, part};
                    pg8::gemm_phase<pg8::EpiRes, pg8::StaticOrder>(lds, g, S, E);
                }
                PHASE_END
            }
            PHASE_BEGIN
            {
                const float* gpost = (half ? g_ffn_post : g_mix_post) + layer * 1024;
                const float* hsrc = (layer == 0 && half == 0) ? x : hout;
                f32x4 gv[4];
#pragma unroll
                for (int j = 0; j < 4; ++j) gv[j] = *((const f32x4*)gpost + lane + 64 * j);
                for (int m = gw; m < MTOK; m += NGW) {
                    const f32x4* pr = (const f32x4*)(part + (size_t)m * 16);
                    const f32x4 p0 = pr[0], p1 = pr[1], p2 = pr[2], p3 = pr[3];
                    const float ssm = (((p0[0] + p0[1]) + (p0[2] + p0[3])) + ((p1[0] + p1[1]) + (p1[2] + p1[3]))) + (((p2[0] + p2[1]) + (p2[2] + p2[3])) + ((p3[0] + p3[1]) + (p3[2] + p3[3])));
                    const float rm = 1.0f / sqrtf(ssm * (1.0f / DM) + NORM_EPS);
                    const f32x4* hr = (const f32x4*)(hsrc + (size_t)m * DM) + lane;
                    const u32x2* mr = (const u32x2*)(MB + (size_t)m * DM) + lane;
                    f32x4 v[4]; float s = 0.f;
#pragma unroll
                    for (int j = 0; j < 4; ++j) { const f32x4 hv = hr[64 * j]; const u32x2 mw = mr[64 * j];
                        v[j][0] = hv[0] + bflo(mw.x) * rm * gv[j][0]; v[j][1] = hv[1] + bfhi(mw.x) * rm * gv[j][1];
                        v[j][2] = hv[2] + bflo(mw.y) * rm * gv[j][2]; v[j][3] = hv[3] + bfhi(mw.y) * rm * gv[j][3];
                        s += (v[j][0] * v[j][0] + v[j][1] * v[j][1]) + (v[j][2] * v[j][2] + v[j][3] * v[j][3]); }
                    s = wave_sum(s);
                    f32x4* ho = (f32x4*)(hout + (size_t)m * DM) + lane; u32x2* o8 = (u32x2*)(HB + (size_t)m * DM) + lane;
#pragma unroll
                    for (int j = 0; j < 4; ++j) { ho[64 * j] = v[j]; u32x2 w; w.x = cvtpk(v[j][0], v[j][1]); w.y = cvtpk(v[j][2], v[j][3]); o8[64 * j] = w; }
                    if (lane == 0) rstd[m] = 1.0f / sqrtf(s * (1.0f / DM) + NORM_EPS);
                }
            }
            PHASE_END
        }
    }
}

constexpr int NPHASES = 1 + 2 * 8 + 2 * 12;

extern "C" void kernel_launch(void* const* d_in, const int* in_sizes, int n_in, void* d_out, int out_size, void* d_ws, size_t ws_size, hipStream_t stream) {
    static int grid = 0;
    if (grid == 0) {
        if (n_in != 17 || out_size != MTOK * DM || ws_size < WS_END) { fprintf(stderr, "kernel_launch: unexpected shapes (n_in %d out %d ws %zu need %zu)\n", n_in, out_size, ws_size, (size_t)WS_END); grid = -1; return; }
        int dev = 0, cus = 0;
        hipGetDevice(&dev); hipDeviceGetAttribute(&cus, hipDeviceAttributeMultiprocessorCount, dev);
        if (hipFuncSetAttribute((const void*)trunk_fwd, hipFuncAttributeMaxDynamicSharedMemorySize, LDS_BYTES) != hipSuccess) { fprintf(stderr, "kernel_launch: hipFuncSetAttribute failed\n"); grid = -1; return; }
        int per_cu = 0;
        hipOccupancyMaxActiveBlocksPerMultiprocessor(&per_cu, (const void*)trunk_fwd, NTHREADS, LDS_BYTES);
        (void)hipGetLastError();
        if (per_cu < 1) fprintf(stderr, "kernel_launch: occupancy query says %d blocks/CU\n", per_cu);
        grid = cus > 0 ? cus : 256;
    }
    if (grid < 0) return;
    hipMemsetAsync((char*)d_ws + WS_CTL, 0, CTL_ZERO_BYTES, stream);
    Params p{};
    for (int i = 0; i < 17; ++i) p.in[i] = (const float*)d_in[i];
    p.out = (float*)d_out; p.ws = (unsigned char*)d_ws;
#if MK_ONE_LAUNCH
    p.ph_lo = 0; p.ph_hi = NPHASES;
    void* args[] = {&p};
    hipError_t e = hipLaunchCooperativeKernel((const void*)trunk_fwd, dim3(grid), dim3(NTHREADS), args, LDS_BYTES, stream);
    if (e != hipSuccess) fprintf(stderr, "cooperative launch failed: %s (grid %d)\n", hipGetErrorString(e), grid);
#else
    for (int ph = 0; ph < NPHASES; ++ph) {
        p.ph_lo = ph; p.ph_hi = ph + 1;
        hipLaunchKernelGGL(trunk_fwd, dim3(grid), dim3(NTHREADS), LDS_BYTES, stream, p);
    }
#endif
}
```
